# Optimizing an MI355X kernel written in HIP

```python
import math
import jax, jax.numpy as jnp
from jax import lax
import numpy as np

D_MODEL = 1024
BATCH = 4
SEQ = 4096
DEPTH = 2

CHUNK = 64
Q_BLOCK = 128
N_HEADS = 8
QK_NOPE_DIM = 128
QK_ROPE_DIM = 64
V_HEAD_DIM = 128
Q_LORA_RANK = 512
KV_LORA_RANK = 256
ROPE_THETA = 10000.0
MAX_POS_OFFSET = 16384
CONV_WIDTH = 3
D_FF = ((8 * D_MODEL // 3 + 255) // 256) * 256
RMS_EPS = 1e-6
N_MLA_LAYERS = (DEPTH + 1) // 2
N_CONV_LAYERS = DEPTH // 2
MLA_IN_DIM = Q_LORA_RANK + KV_LORA_RANK + QK_ROPE_DIM

kernel_name = "hybrid_mla_shortconv_swiglu_trunk"


def rms_norm(x, g):
    xf = x.astype(jnp.float32)
    y = xf * lax.rsqrt(jnp.mean(xf * xf, axis=-1, keepdims=True) + RMS_EPS)
    return (y * g.astype(jnp.float32)).astype(x.dtype)


def rope_tables(positions):
    inv_freq = 1.0 / (ROPE_THETA ** (jnp.arange(0, QK_ROPE_DIM, 2, dtype=jnp.float32) / QK_ROPE_DIM))
    ang = positions.astype(jnp.float32)[..., None] * inv_freq
    return jnp.cos(ang), jnp.sin(ang)


def apply_rope(x, cos, sin):
    xf = x.astype(jnp.float32)
    x1, x2 = jnp.split(xf, 2, axis=-1)
    out = jnp.concatenate([x1 * cos - x2 * sin, x1 * sin + x2 * cos], axis=-1)
    return out.astype(x.dtype)


def chunk_causal_mla_attention(q_n, q_r, k_n, k_r, v):
    bsz, seq, h, _ = q_n.shape
    nb = seq // Q_BLOCK
    scale = 1.0 / math.sqrt(QK_NOPE_DIM + QK_ROPE_DIM)
    qn_b = q_n.reshape(bsz, nb, Q_BLOCK, h, QK_NOPE_DIM).transpose(1, 0, 2, 3, 4)
    qr_b = q_r.reshape(bsz, nb, Q_BLOCK, h, QK_ROPE_DIM).transpose(1, 0, 2, 3, 4)
    k_chunk = jnp.arange(seq) // CHUNK

    def one_block(args):
        qn, qr, blk = args
        q_chunk = (blk * Q_BLOCK + jnp.arange(Q_BLOCK)) // CHUNK
        s = (jnp.einsum('bqhd,bkhd->bhqk', qn, k_n).astype(jnp.float32)
             + jnp.einsum('bqhd,bkd->bhqk', qr, k_r).astype(jnp.float32)) * scale
        mask = k_chunk[None, :] <= q_chunk[:, None]
        s = jnp.where(mask[None, None], s, jnp.float32(-1e30))
        p = jax.nn.softmax(s, axis=-1).astype(v.dtype)
        return jnp.einsum('bhqk,bkhd->bqhd', p, v)

    out = lax.map(one_block, (qn_b, qr_b, jnp.arange(nb)))
    return out.transpose(1, 0, 2, 3, 4).reshape(bsz, seq, h, V_HEAD_DIM)


def mla_mixer(h, positions, w_in, g_cq, g_ckv, w_uq, w_ukv, w_o):
    bsz, seq, _ = h.shape
    proj = h @ w_in
    c_q = proj[..., :Q_LORA_RANK]
    c_kv = proj[..., Q_LORA_RANK:Q_LORA_RANK + KV_LORA_RANK]
    k_r = proj[..., Q_LORA_RANK + KV_LORA_RANK:]
    c_q = rms_norm(c_q, g_cq)
    c_kv = rms_norm(c_kv, g_ckv)
    q = (c_q @ w_uq).reshape(bsz, seq, N_HEADS, QK_NOPE_DIM + QK_ROPE_DIM)
    q_n, q_r = q[..., :QK_NOPE_DIM], q[..., QK_NOPE_DIM:]
    kv = (c_kv @ w_ukv).reshape(bsz, seq, N_HEADS, QK_NOPE_DIM + V_HEAD_DIM)
    k_n, v = kv[..., :QK_NOPE_DIM], kv[..., QK_NOPE_DIM:]
    cos, sin = rope_tables(positions)
    q_r = apply_rope(q_r, cos[:, :, None, :], sin[:, :, None, :])
    k_r = apply_rope(k_r, cos, sin)
    attn = chunk_causal_mla_attention(q_n, q_r, k_n, k_r, v)
    return attn.reshape(bsz, seq, N_HEADS * V_HEAD_DIM) @ w_o


def short_conv_mixer(h, w_in, conv_w, w_out):
    bcx = h @ w_in
    b_gate = bcx[..., :D_MODEL]
    c_gate = bcx[..., D_MODEL:2 * D_MODEL]
    xp = bcx[..., 2 * D_MODEL:]
    u = c_gate * xp
    u_conv = lax.conv_general_dilated(
        u, conv_w[:, None, :].astype(u.dtype), window_strides=(1,),
        padding=[(CONV_WIDTH - 1, 0)], dimension_numbers=('NWC', 'WIO', 'NWC'),
        feature_group_count=D_MODEL)
    return (b_gate * u_conv) @ w_out


def swiglu(h, w_gate, w_up, w_down):
    return (jax.nn.silu(h @ w_gate) * (h @ w_up)) @ w_down


def setup_inputs(seed: int = 0) -> dict:
    key = jax.random.key(seed)
    ks = jax.random.split(key, 24)

    def w(k, shape, fan_in):
        return jax.random.normal(k, shape, jnp.float32) * (fan_in ** -0.5)

    def gain(k, shape):
        return 1.0 + 0.05 * jax.random.normal(k, shape, jnp.float32)

    x = jax.random.normal(ks[0], (BATCH, SEQ, D_MODEL), jnp.float32)
    offset = jax.random.randint(ks[1], (BATCH, 1), 0, MAX_POS_OFFSET, dtype=jnp.int32)
    positions = (offset + jnp.arange(SEQ, dtype=jnp.int32)[None, :]).astype(jnp.int32)
    L_a, L_b = N_MLA_LAYERS, N_CONV_LAYERS
    return {
        "x": x,
        "positions": positions,
        "mla_norm": gain(ks[2], (L_a, D_MODEL)),
        "mla_w_in": w(ks[3], (L_a, D_MODEL, MLA_IN_DIM), D_MODEL),
        "mla_g_cq": gain(ks[4], (L_a, Q_LORA_RANK)),
        "mla_g_ckv": gain(ks[5], (L_a, KV_LORA_RANK)),
        "mla_w_uq": w(ks[6], (L_a, Q_LORA_RANK, N_HEADS * (QK_NOPE_DIM + QK_ROPE_DIM)), Q_LORA_RANK),
        "mla_w_ukv": w(ks[7], (L_a, KV_LORA_RANK, N_HEADS * (QK_NOPE_DIM + V_HEAD_DIM)), KV_LORA_RANK),
        "mla_w_o": w(ks[8], (L_a, N_HEADS * V_HEAD_DIM, D_MODEL), N_HEADS * V_HEAD_DIM),
        "conv_norm": gain(ks[9], (L_b, D_MODEL)),
        "conv_w_in": w(ks[10], (L_b, D_MODEL, 3 * D_MODEL), D_MODEL),
        "conv_w": w(ks[11], (L_b, CONV_WIDTH, D_MODEL), CONV_WIDTH),
        "conv_w_out": w(ks[12], (L_b, D_MODEL, D_MODEL), D_MODEL),
        "ffn_norm": gain(ks[13], (DEPTH, D_MODEL)),
        "ffn_w_gate": w(ks[14], (DEPTH, D_MODEL, D_FF), D_MODEL),
        "ffn_w_up": w(ks[15], (DEPTH, D_MODEL, D_FF), D_MODEL),
        "ffn_w_down": w(ks[16], (DEPTH, D_FF, D_MODEL), D_FF),
        "final_norm": gain(ks[17], (D_MODEL,)),
    }


def reference(x, positions, mla_norm, mla_w_in, mla_g_cq, mla_g_ckv, mla_w_uq,
              mla_w_ukv, mla_w_o, conv_norm, conv_w_in, conv_w, conv_w_out,
              ffn_norm, ffn_w_gate, ffn_w_up, ffn_w_down, final_norm):
    h = x
    for i in range(DEPTH):
        j = i // 2
        if i % 2 == 0:
            h = h + mla_mixer(rms_norm(h, mla_norm[j]), positions, mla_w_in[j],
                              mla_g_cq[j], mla_g_ckv[j], mla_w_uq[j], mla_w_ukv[j], mla_w_o[j])
        else:
            h = h + short_conv_mixer(rms_norm(h, conv_norm[j]), conv_w_in[j],
                                     conv_w[j], conv_w_out[j])
        h = h + swiglu(rms_norm(h, ffn_norm[i]), ffn_w_gate[i], ffn_w_up[i], ffn_w_down[i])
    return rms_norm(h, final_norm)
```

```cpp
#include <hip/hip_runtime.h>
#include <cstdio>
#include <cstdint>

constexpr int BATCH = 4, SEQ = 4096, M = BATCH * SEQ, D = 1024, NH = 8, NOPE = 128, ROPE = 64, VD = 128;
constexpr int QLR = 512, KVLR = 256, INDIM = QLR + KVLR + ROPE  , QKD = NOPE + ROPE  , DFF = 2816, CHUNK = 64;
constexpr float RMS_EPS = 1e-6f;
constexpr float C2 = 0.07216878364870322f * 1.4426950408889634f;

constexpr size_t MiB = 1u << 20;
constexpr size_t WS_CTL = 0, WS_W = 2 * MiB, WS_ROPE = 50 * MiB, WS_CQ = 54 * MiB, WS_CKV = 70 * MiB, WS_XN = 78 * MiB;
constexpr size_t WS_Q = 110 * MiB, WS_KN = 158 * MiB, WS_KR = 190 * MiB, WS_V = 192 * MiB, WS_O = 224 * MiB, WS_END = 256 * MiB;
constexpr size_t WS_ACT = 110 * MiB, WS_U = 110 * MiB, WS_Y = 142 * MiB, WS_TMP = 110 * MiB;

typedef unsigned short bf16;
__device__ __forceinline__ unsigned f2bf(float f) { unsigned u = __builtin_bit_cast(unsigned, f); return (u + 0x7fffu + ((u >> 16) & 1u)) >> 16; }
__device__ __forceinline__ float bf2f(bf16 b) { return __builtin_bit_cast(float, (unsigned)b << 16); }
__device__ __forceinline__ float wave_sum(float v) {
#pragma unroll
    for (int o = 1; o < 64; o <<= 1) v += __shfl_xor(v, o);
    return v;
}

template <bool OUT_F32> __global__ void __launch_bounds__(256) nv_rmsnorm(const float* in, const float* g, void* out) {
    const int row = blockIdx.x * 4 + (threadIdx.x >> 6), lane = threadIdx.x & 63;
    const float* r = in + (size_t)row * D; float v[16]; float s = 0.f;
#pragma unroll
    for (int i = 0; i < 16; ++i) { v[i] = r[lane + 64 * i]; s += v[i] * v[i]; }
    const float rs = 1.0f / sqrtf(wave_sum(s) * (1.0f / D) + RMS_EPS);
#pragma unroll
    for (int i = 0; i < 16; ++i) { const float y = v[i] * rs * g[lane + 64 * i];
        if (OUT_F32) ((float*)out)[(size_t)row * D + lane + 64 * i] = y; else ((bf16*)out)[(size_t)row * D + lane + 64 * i] = (bf16)f2bf(y); }
}
__global__ void __launch_bounds__(256) nv_rope_tab(const int* pos, float* ct, float* st) {
    const int idx = blockIdx.x * 256 + threadIdx.x; if (idx >= M * 32) return;
    const int m = idx >> 5, i = idx & 31;
    const float inv = exp2f(-(float)i * (13.287712379549449f / 32.0f));
    const float ang = (float)pos[m] * inv;
    const double a = (double)ang; const double n = rint(a * 0.15915494309189535); const double r = (a - n * 6.283185307179586);
    ct[idx] = cosf((float)r); st[idx] = sinf((float)r);
}
struct NvP {
    const bf16* A; int K;
    const float* W1; const float* W2; int ldw; int c1, c2;
    int N;
    float* of; const float* base;
    bf16* o1; bf16* o2; bf16* o3;
    const float* ct; const float* st; const float* cw; const bf16* U;
};
template <int MODE> __global__ void __launch_bounds__(256) nv_gemm(NvP p) {
    __shared__ float As[32][33]; __shared__ float Ws[32][64]; __shared__ float Ws2[32][64];
    constexpr bool DUAL = (MODE == 4 || MODE == 5);
    const int tid = threadIdx.x, col = tid & 63, rg = tid >> 6, row0 = blockIdx.y * 32, col0 = blockIdx.x * 64;
    float a1[8], a2[8];
#pragma unroll
    for (int r = 0; r < 8; ++r) { a1[r] = 0.f; a2[r] = 0.f; }
    for (int k0 = 0; k0 < p.K; k0 += 32) {
#pragma unroll
        for (int i = 0; i < 4; ++i) { const int idx = tid + i * 256, r = idx >> 5, c = idx & 31; As[r][c] = bf2f(p.A[(size_t)(row0 + r) * p.K + k0 + c]); }
#pragma unroll
        for (int i = 0; i < 8; ++i) { const int idx = tid + i * 256, kk = idx >> 6, cc = idx & 63;
            Ws[kk][cc] = p.W1[(size_t)(k0 + kk) * p.ldw + p.c1 + col0 + cc];
            if (DUAL) Ws2[kk][cc] = p.W2[(size_t)(k0 + kk) * p.ldw + p.c2 + col0 + cc]; }
        __syncthreads();
#pragma unroll 8
        for (int kk = 0; kk < 32; ++kk) { const float w = Ws[kk][col]; const float w2 = DUAL ? Ws2[kk][col] : 0.f;
#pragma unroll
            for (int r = 0; r < 8; ++r) { const float a = As[rg * 8 + r][kk]; a1[r] += a * w; if (DUAL) a2[r] += a * w2; } }
        __syncthreads();
    }
    const int n = col0 + col;
#pragma unroll
    for (int r = 0; r < 8; ++r) {
        const int m = row0 + rg * 8 + r; const float v = a1[r];
        if (MODE == 0) p.of[(size_t)m * p.N + n] = v;
        if (MODE == 1) { const int h = n / QKD, d = n % QKD; float o = v;
            const float part = __shfl_xor(v, 32);
            if (d >= NOPE) { const int i = (d - NOPE) & 31; const float c = p.ct[m * 32 + i], s = p.st[m * 32 + i];
                o = (d - NOPE < 32) ? (v * c - part * s) : (part * s + v * c); }
            p.o1[(size_t)m * (NH * QKD) + h * QKD + d] = (bf16)f2bf(o * C2); }
        if (MODE == 2) { const int h = n >> 8, c = n & 255; if (c < 128) p.o1[(size_t)m * 1024 + h * 128 + c] = (bf16)f2bf(v); else p.o2[(size_t)m * 1024 + h * 128 + c - 128] = (bf16)f2bf(v); }
        if (MODE == 3) p.of[(size_t)m * p.N + n] = p.base[(size_t)m * p.N + n] + v;
        if (MODE == 4) { const float g = v, u = a2[r]; p.o1[(size_t)m * p.N + n] = (bf16)f2bf(g / (1.0f + __expf(-g)) * u); }
        if (MODE == 5) p.o1[(size_t)m * p.N + n] = (bf16)f2bf(v * a2[r]);
        if (MODE == 6) { const int s = m % SEQ; const float u0 = bf2f(p.U[(size_t)m * D + n]), u1 = s >= 1 ? bf2f(p.U[(size_t)(m - 1) * D + n]) : 0.f, u2 = s >= 2 ? bf2f(p.U[(size_t)(m - 2) * D + n]) : 0.f;
            p.o1[(size_t)m * D + n] = (bf16)f2bf(v * (p.cw[n] * u2 + p.cw[D + n] * u1 + p.cw[2 * D + n] * u0)); }
    }
}
__global__ void __launch_bounds__(256) nv_proj_finish(const float* tmp, const float* gq, const float* gkv, const float* ct, const float* st, bf16* CQ, bf16* CKV, bf16* KR) {
    const int m = blockIdx.x * 4 + (threadIdx.x >> 6), lane = threadIdx.x & 63; const float* r = tmp + (size_t)m * INDIM;
    float v[8]; float s = 0.f;
#pragma unroll
    for (int i = 0; i < 8; ++i) { v[i] = r[lane + 64 * i]; s += v[i] * v[i]; }
    float rs = 1.0f / sqrtf(wave_sum(s) * (1.0f / QLR) + RMS_EPS);
#pragma unroll
    for (int i = 0; i < 8; ++i) CQ[(size_t)m * QLR + lane + 64 * i] = (bf16)f2bf(v[i] * rs * gq[lane + 64 * i]);
    s = 0.f;
#pragma unroll
    for (int i = 0; i < 4; ++i) { v[i] = r[QLR + lane + 64 * i]; s += v[i] * v[i]; }
    rs = 1.0f / sqrtf(wave_sum(s) * (1.0f / KVLR) + RMS_EPS);
#pragma unroll
    for (int i = 0; i < 4; ++i) CKV[(size_t)m * KVLR + lane + 64 * i] = (bf16)f2bf(v[i] * rs * gkv[lane + 64 * i]);
    if (lane < 32) { const float x1 = r[QLR + KVLR + lane], x2 = r[QLR + KVLR + 32 + lane], c = ct[m * 32 + lane], sn = st[m * 32 + lane];
        KR[(size_t)m * ROPE + lane] = (bf16)f2bf(x1 * c - x2 * sn); KR[(size_t)m * ROPE + 32 + lane] = (bf16)f2bf(x1 * sn + x2 * c); }
}
__global__ void __launch_bounds__(256) nv_attn(const bf16* Q, const bf16* KN, const bf16* KR, const bf16* V, bf16* O) {
    const int w = blockIdx.x * 4 + (threadIdx.x >> 6), lane = threadIdx.x & 63;
    const int h = w & 7, m = w >> 3, b = m / SEQ, s = m % SEQ;
    const bf16* q = Q + (size_t)m * (NH * QKD) + h * QKD;
    const float q0 = bf2f(q[lane]), q1 = bf2f(q[64 + lane]), q2 = bf2f(q[128 + lane]);
    const int nk = (s / CHUNK + 1) * CHUNK;
    float mx = -1e30f, l = 0.f, o0 = 0.f, o1 = 0.f;
    for (int j = 0; j < nk; ++j) {
        const size_t kr = (size_t)(b * SEQ + j);
        const float k0 = bf2f(KN[kr * 1024 + h * 128 + lane]), k1 = bf2f(KN[kr * 1024 + h * 128 + 64 + lane]), k2 = bf2f(KR[kr * ROPE + lane]);
        const float sc = wave_sum(q0 * k0 + q1 * k1 + q2 * k2);
        const float mn = fmaxf(mx, sc), al = exp2f(mx - mn), pp = exp2f(sc - mn);
        l = l * al + pp; o0 = o0 * al + pp * bf2f(V[kr * 1024 + h * 128 + lane]); o1 = o1 * al + pp * bf2f(V[kr * 1024 + h * 128 + 64 + lane]); mx = mn;
    }
    O[(size_t)m * 1024 + h * 128 + lane] = (bf16)f2bf(o0 / l); O[(size_t)m * 1024 + h * 128 + 64 + lane] = (bf16)f2bf(o1 / l);
}

extern "C" void kernel_launch(void* const* d_in, const int* in_sizes, int n_in, void* d_out, int out_size, void* d_ws, size_t ws_size, hipStream_t stream) {
    if (n_in != 18 || out_size != M * D || ws_size < WS_END) { fprintf(stderr, "kernel_launch: unexpected shapes n_in %d out %d ws %zu\n", n_in, out_size, ws_size); return; }
    const float* x = (const float*)d_in[0]; const int* pos = (const int*)d_in[1];
    const float *mla_norm = (const float*)d_in[2], *mla_w_in = (const float*)d_in[3], *g_cq = (const float*)d_in[4], *g_ckv = (const float*)d_in[5], *w_uq = (const float*)d_in[6], *w_ukv = (const float*)d_in[7], *w_o = (const float*)d_in[8];
    const float *conv_norm = (const float*)d_in[9], *conv_w_in = (const float*)d_in[10], *conv_w = (const float*)d_in[11], *conv_w_out = (const float*)d_in[12];
    const float *ffn_norm = (const float*)d_in[13], *w_gate = (const float*)d_in[14], *w_up = (const float*)d_in[15], *w_down = (const float*)d_in[16], *final_norm = (const float*)d_in[17];
    unsigned char* ws = (unsigned char*)d_ws; float* H = (float*)d_out;
    float* ct = (float*)(ws + WS_ROPE); float* st = ct + M * 32;
    bf16 *CQ = (bf16*)(ws + WS_CQ), *CKV = (bf16*)(ws + WS_CKV), *XN = (bf16*)(ws + WS_XN), *Qb = (bf16*)(ws + WS_Q), *KN = (bf16*)(ws + WS_KN), *KR = (bf16*)(ws + WS_KR), *Vb = (bf16*)(ws + WS_V), *Ob = (bf16*)(ws + WS_O);
    bf16 *ACT = (bf16*)(ws + WS_ACT), *U = (bf16*)(ws + WS_U), *Y = (bf16*)(ws + WS_Y); float* TMP = (float*)(ws + WS_TMP);
    const dim3 blk(256);
    nv_rmsnorm<false><<<M / 4, blk, 0, stream>>>(x, mla_norm, XN);
    nv_rope_tab<<<M * 32 / 256, blk, 0, stream>>>(pos, ct, st);
    { NvP p{}; p.A = XN; p.K = D; p.W1 = mla_w_in; p.ldw = INDIM; p.N = INDIM; p.of = TMP; nv_gemm<0><<<dim3(INDIM / 64, M / 32), blk, 0, stream>>>(p);
      nv_proj_finish<<<M / 4, blk, 0, stream>>>(TMP, g_cq, g_ckv, ct, st, CQ, CKV, KR); }
    { NvP p{}; p.A = CQ; p.K = QLR; p.W1 = w_uq; p.ldw = NH * QKD; p.N = NH * QKD; p.o1 = Qb; p.ct = ct; p.st = st; nv_gemm<1><<<dim3(NH * QKD / 64, M / 32), blk, 0, stream>>>(p); }
    { NvP p{}; p.A = CKV; p.K = KVLR; p.W1 = w_ukv; p.ldw = 2048; p.N = 2048; p.o1 = KN; p.o2 = Vb; nv_gemm<2><<<dim3(2048 / 64, M / 32), blk, 0, stream>>>(p); }
    nv_attn<<<M * NH / 4, blk, 0, stream>>>(Qb, KN, KR, Vb, Ob);
    { NvP p{}; p.A = Ob; p.K = D; p.W1 = w_o; p.ldw = D; p.N = D; p.of = H; p.base = x; nv_gemm<3><<<dim3(D / 64, M / 32), blk, 0, stream>>>(p);
      nv_rmsnorm<false><<<M / 4, blk, 0, stream>>>(H, ffn_norm, XN); }
    for (int layer = 0; layer < 2; ++layer) {
        if (layer == 1) {
            { NvP p{}; p.A = XN; p.K = D; p.W1 = conv_w_in; p.W2 = conv_w_in; p.ldw = 3 * D; p.c1 = D; p.c2 = 2 * D; p.N = D; p.o1 = U; nv_gemm<5><<<dim3(D / 64, M / 32), blk, 0, stream>>>(p); }
            { NvP p{}; p.A = XN; p.K = D; p.W1 = conv_w_in; p.ldw = 3 * D; p.c1 = 0; p.N = D; p.o1 = Y; p.U = U; p.cw = conv_w; nv_gemm<6><<<dim3(D / 64, M / 32), blk, 0, stream>>>(p); }
            { NvP p{}; p.A = Y; p.K = D; p.W1 = conv_w_out; p.ldw = D; p.N = D; p.of = H; p.base = H; nv_gemm<3><<<dim3(D / 64, M / 32), blk, 0, stream>>>(p);
              nv_rmsnorm<false><<<M / 4, blk, 0, stream>>>(H, ffn_norm + D, XN); }
        }
        { NvP p{}; p.A = XN; p.K = D; p.W1 = w_gate + (size_t)layer * D * DFF; p.W2 = w_up + (size_t)layer * D * DFF; p.ldw = DFF; p.N = DFF; p.o1 = ACT; nv_gemm<4><<<dim3(DFF / 64, M / 32), blk, 0, stream>>>(p); }
        { NvP p{}; p.A = ACT; p.K = DFF; p.W1 = w_down + (size_t)layer * DFF * D; p.ldw = D; p.N = D; p.of = H; p.base = H; nv_gemm<3><<<dim3(D / 64, M / 32), blk, 0, stream>>>(p); }
        if (layer == 0) nv_rmsnorm<false><<<M / 4, blk, 0, stream>>>(H, conv_norm, XN);
        else nv_rmsnorm<true><<<M / 4, blk, 0, stream>>>(H, final_norm, H);
    }
}
```
